# Optimizing an MI355X kernel written in HIP

```python
import jax, jax.numpy as jnp
from jax import lax
import numpy as np

D_MODEL = 1024
BATCH = 32
SEQ = 256
DEPTH = 1
DEC_BATCH = 4
DEC_SEQ = 1024
PAST_LEN = 256

GRID_W = 64
N_Q_HEADS = 8
N_KV_HEADS = 2
Q_PER_KV = N_Q_HEADS // N_KV_HEADS
HEAD_DIM = 64
WINDOW = 128
BLOCK = 128
ROPE_BASE = 10000.0
GLA_HEADS = 4
GLA_DK = 64
GLA_DV = 128
GLA_LOW_RANK = 16
GLA_TAU = 16.0
GLA_CHUNK = 16
D_FF = 2816
N_MOD = 9
EPS = 1e-6
NEG = -1e30

ATT_Q = N_Q_HEADS * HEAD_DIM
ATT_KV = N_KV_HEADS * HEAD_DIM
GLA_QK = GLA_HEADS * GLA_DK
GLA_V = GLA_HEADS * GLA_DV
MIX_WIDTH = ATT_Q + GLA_V
SPLIT_SIZES = (ATT_Q, ATT_KV, ATT_KV, GLA_QK, GLA_QK, GLA_V, GLA_V, GLA_LOW_RANK, GLA_LOW_RANK)
IN_WIDTH = ATT_Q + 2 * ATT_KV + 2 * GLA_QK + 2 * GLA_V + 2 * GLA_LOW_RANK

kernel_name = 'hybrid_gla_swa_diffusion_step'


def rmsnorm(x, g):
    xf = x.astype(jnp.float32)
    y = xf * lax.rsqrt(jnp.mean(xf * xf, axis=-1, keepdims=True) + EPS)
    return (y * g.astype(jnp.float32)).astype(x.dtype)


def swiglu(h, w1, w3, w2):
    return (jax.nn.silu(h @ w1) * (h @ w3)) @ w2


def ada_modulation(cond, w_ada, b_ada):
    m = jax.nn.silu(cond) @ w_ada + b_ada
    return m.reshape(cond.shape[0], N_MOD, D_MODEL)


def split_proj(p):
    points, acc = [], 0
    for s in SPLIT_SIZES[:-1]:
        acc += s
        points.append(acc)
    return jnp.split(p, points, axis=-1)


def _rotate_half(x, ang):
    f = ang.shape[-1]
    cos = jnp.cos(ang)[:, None, :]
    sin = jnp.sin(ang)[:, None, :]
    x1, x2 = x[..., :f], x[..., f:]
    return jnp.concatenate([x1 * cos - x2 * sin, x1 * sin + x2 * cos], axis=-1)


def rope_2d(x):
    L = x.shape[1]
    rows = L // GRID_W
    row = jnp.repeat(jnp.arange(rows, dtype=jnp.float32), GRID_W)
    col = jnp.tile(jnp.arange(GRID_W, dtype=jnp.float32), rows)
    half = HEAD_DIM // 2
    inv_freq = ROPE_BASE ** (-jnp.arange(0, half, 2, dtype=jnp.float32) / half)
    xf = x.astype(jnp.float32)
    xr = _rotate_half(xf[..., :half], row[:, None] * inv_freq[None, :])
    xc = _rotate_half(xf[..., half:], col[:, None] * inv_freq[None, :])
    return jnp.concatenate([xr, xc], axis=-1).astype(x.dtype)


def sink_softmax(s, sink):
    sk = sink.astype(jnp.float32).reshape(N_KV_HEADS, Q_PER_KV)[None, :, :, None, None]
    m = jnp.maximum(jnp.max(s, axis=-1, keepdims=True), sk)
    p = jnp.exp(s - m)
    return p / (jnp.sum(p, axis=-1, keepdims=True) + jnp.exp(sk - m))


def context_attention(q, k, v, sink):
    B, L = q.shape[0], q.shape[1]
    nb = L // BLOCK
    scale = HEAD_DIM ** -0.5
    qb = q.reshape(B, nb, BLOCK, N_KV_HEADS, Q_PER_KV, HEAD_DIM).swapaxes(0, 1)

    def one_block(qi):
        s = jnp.einsum('bqgrd,bkgd->bgrqk', qi, k, preferred_element_type=jnp.float32) * scale
        p = sink_softmax(s, sink)
        return jnp.einsum('bgrqk,bkgd->bqgrd', p.astype(v.dtype), v)

    o = lax.map(one_block, qb)
    return o.swapaxes(0, 1).reshape(B, L, ATT_Q)


def latent_attention(q, k, v, k_ctx, v_ctx, sink):
    B, L = q.shape[0], q.shape[1]
    nb = L // BLOCK
    scale = HEAD_DIM ** -0.5
    pad = ((0, 0), (BLOCK, BLOCK), (0, 0), (0, 0))
    kp = jnp.pad(k, pad).reshape(B, nb + 2, BLOCK, N_KV_HEADS, HEAD_DIM)
    vp = jnp.pad(v, pad).reshape(B, nb + 2, BLOCK, N_KV_HEADS, HEAD_DIM)
    k_band = jnp.concatenate([kp[:, :-2], kp[:, 1:-1], kp[:, 2:]], axis=2).swapaxes(0, 1)
    v_band = jnp.concatenate([vp[:, :-2], vp[:, 1:-1], vp[:, 2:]], axis=2).swapaxes(0, 1)
    qb = q.reshape(B, nb, BLOCK, N_KV_HEADS, Q_PER_KV, HEAD_DIM).swapaxes(0, 1)
    r = jnp.arange(BLOCK)[:, None]
    j = jnp.arange(3 * BLOCK)[None, :]
    in_window = jnp.abs(j - BLOCK - r) <= WINDOW

    def one_block(args):
        i, qi, ki, vi = args
        kpos = (i - 1) * BLOCK + j
        valid = in_window & (kpos >= 0) & (kpos < L)
        s_loc = jnp.einsum('bqgrd,bkgd->bgrqk', qi, ki, preferred_element_type=jnp.float32) * scale
        s_loc = jnp.where(valid, s_loc, NEG)
        s_ctx = jnp.einsum('bqgrd,bkgd->bgrqk', qi, k_ctx, preferred_element_type=jnp.float32) * scale
        p = sink_softmax(jnp.concatenate([s_loc, s_ctx], axis=-1), sink)
        vals = jnp.concatenate([vi, v_ctx], axis=1)
        return jnp.einsum('bgrqk,bkgd->bqgrd', p.astype(vals.dtype), vals)

    o = lax.map(one_block, (jnp.arange(nb), qb, k_band, v_band))
    return o.swapaxes(0, 1).reshape(B, L, ATT_Q)


def gla_scan(q, k, v, log_a, s0):
    B, L, H, dk = q.shape
    dv = v.shape[-1]
    n, C = L // GLA_CHUNK, GLA_CHUNK

    def chunks(t):
        return t.reshape(B, n, C, H, t.shape[-1]).transpose(0, 1, 3, 2, 4)

    qc, kc, vc, ac = chunks(q), chunks(k), chunks(v), chunks(log_a)
    b = jnp.cumsum(ac, axis=3)
    tri = jnp.tril(jnp.ones((C, C), dtype=bool))[:, :, None]
    diff = b[:, :, :, :, None, :] - b[:, :, :, None, :, :]
    decay = jnp.exp(jnp.where(tri, diff, NEG))
    scores = jnp.einsum('bnhtd,bnhsd,bnhtsd->bnhts', qc, kc, decay)
    o_intra = jnp.einsum('bnhts,bnhsv->bnhtv', scores, vc)
    b_last = b[:, :, :, -1:, :]
    q_in = qc * jnp.exp(b)
    k_in = kc * jnp.exp(b_last - b)
    a_last = jnp.exp(b_last[:, :, :, 0, :])

    def step(S, xs):
        qi, ki, vi, ai = xs
        o = jnp.einsum('bhtd,bhdv->bhtv', qi, S)
        S = ai[..., None] * S + jnp.einsum('bhtd,bhtv->bhdv', ki, vi)
        return S, o

    xs = (q_in.swapaxes(0, 1), k_in.swapaxes(0, 1), vc.swapaxes(0, 1), a_last.swapaxes(0, 1))
    s_final, o_inter = lax.scan(step, s0, xs)
    o = o_intra + o_inter.swapaxes(0, 1)
    return o.transpose(0, 1, 3, 2, 4).reshape(B, L, H, dv), s_final


def gla_mixer(gq, gk, gv, gg, lr_f, lr_b, w_up, b_up, norm_w, s0_f, s0_b):
    B, L = gq.shape[0], gq.shape[1]
    f32 = jnp.float32
    q = gq.astype(f32).reshape(B, L, GLA_HEADS, GLA_DK) * (GLA_DK ** -0.5)
    k = gk.astype(f32).reshape(B, L, GLA_HEADS, GLA_DK)
    v = gv.astype(f32).reshape(B, L, GLA_HEADS, GLA_DV)

    def log_gate(lr, d):
        z = lr.astype(f32) @ w_up[d].astype(f32) + b_up[d].astype(f32)
        return (jax.nn.log_sigmoid(z) / GLA_TAU).reshape(B, L, GLA_HEADS, GLA_DK)

    def flip(t):
        return jnp.flip(t, axis=1)

    o_f, s_f = gla_scan(q, k, v, log_gate(lr_f, 0), s0_f)
    o_b, s_b = gla_scan(flip(q), flip(k), flip(v), flip(log_gate(lr_b, 1)), s0_b)
    o = o_f + flip(o_b)
    o = o * lax.rsqrt(jnp.mean(o * o, axis=-1, keepdims=True) + EPS) * norm_w.astype(f32)
    o = o * jax.nn.silu(gg.astype(f32).reshape(B, L, GLA_HEADS, GLA_DV))
    return o.reshape(B, L, GLA_V).astype(gq.dtype), s_f, s_b


def mixer_context(h, w):
    B, L = h.shape[0], h.shape[1]
    aq, ak, av, gq, gk, gv, gg, lf, lb = split_proj(h @ w['w_in'])
    k = ak.reshape(B, L, N_KV_HEADS, HEAD_DIM)
    v = av.reshape(B, L, N_KV_HEADS, HEAD_DIM)
    att = context_attention(aq.reshape(B, L, N_Q_HEADS, HEAD_DIM), k, v, w['attn_sink'])
    s0 = jnp.zeros((B, GLA_HEADS, GLA_DK, GLA_DV), jnp.float32)
    gla, s_f, s_b = gla_mixer(gq, gk, gv, gg, lf, lb, w['gla_w_up'], w['gla_b_up'], w['gla_norm'], s0, s0)
    out = jnp.concatenate([att, gla], axis=-1) @ w['w_out']
    return out, (k, v, s_f, s_b)


def mixer_latent(h, w, k_ctx, v_ctx, s0_f, s0_b):
    B, L = h.shape[0], h.shape[1]
    aq, ak, av, gq, gk, gv, gg, lf, lb = split_proj(h @ w['w_in'])
    q = rope_2d(aq.reshape(B, L, N_Q_HEADS, HEAD_DIM))
    k = rope_2d(ak.reshape(B, L, N_KV_HEADS, HEAD_DIM))
    v = av.reshape(B, L, N_KV_HEADS, HEAD_DIM)
    att = latent_attention(q, k, v, k_ctx, v_ctx, w['attn_sink'])
    gla, _, _ = gla_mixer(gq, gk, gv, gg, lf, lb, w['gla_w_up'], w['gla_b_up'], w['gla_norm'],
                          s0_f.astype(jnp.float32), s0_b.astype(jnp.float32))
    out = jnp.concatenate([att, gla], axis=-1) @ w['w_out']
    return out, ()


def trunk_layer(x, mod, w, mixer_fn):
    def modulated(x, i):
        return rmsnorm(x, w['norm_pre'][i]) * (1 + mod[:, 3 * i + 1, None]) + mod[:, 3 * i, None]

    def residual(x, out, i, weight):
        return x + weight * mod[:, 3 * i + 2, None] * rmsnorm(out, w['norm_post'][i])

    x = residual(x, swiglu(modulated(x, 0), w['ffn_w1'][0], w['ffn_w3'][0], w['ffn_w2'][0]), 0, 0.5)
    mix, ctx_tensors = mixer_fn(modulated(x, 1))
    x = residual(x, mix, 1, 1.0)
    x = residual(x, swiglu(modulated(x, 2), w['ffn_w1'][1], w['ffn_w3'][1], w['ffn_w2'][1]), 2, 0.5)
    return x, ctx_tensors


def setup_inputs(seed: int = 0) -> dict:
    key = jax.random.key(seed)
    ks = jax.random.split(key, 21)
    D = D_MODEL

    def nrm(k, shape, s):
        return jax.random.normal(k, shape, jnp.float32) * s

    return {
        'x_prompt': nrm(ks[0], (BATCH, SEQ, D), 1.0),
        'x_sample': nrm(ks[1], (DEC_BATCH, DEC_SEQ, D), 1.0),
        'cache_k': nrm(ks[2], (DEC_BATCH, DEPTH, PAST_LEN, N_KV_HEADS, HEAD_DIM), 1.0),
        'cache_v': nrm(ks[3], (DEC_BATCH, DEPTH, PAST_LEN, N_KV_HEADS, HEAD_DIM), 1.0),
        'state_gla_fwd': nrm(ks[4], (DEC_BATCH, DEPTH, GLA_HEADS, GLA_DK, GLA_DV), 0.5),
        'state_gla_bwd': nrm(ks[5], (DEC_BATCH, DEPTH, GLA_HEADS, GLA_DK, GLA_DV), 0.5),
        'c': nrm(ks[6], (DEC_BATCH, D), 1.0),
        'c_ctx': nrm(ks[7], (D,), 1.0),
        'w_ada': nrm(ks[8], (DEPTH, D, N_MOD * D), 0.5 * D ** -0.5),
        'b_ada': nrm(ks[9], (DEPTH, N_MOD * D), 0.02),
        'norm_pre': 1.0 + nrm(ks[10], (DEPTH, 3, D), 0.1),
        'norm_post': 1.0 + nrm(ks[11], (DEPTH, 3, D), 0.1),
        'ffn_w1': nrm(ks[12], (DEPTH, 2, D, D_FF), D ** -0.5),
        'ffn_w3': nrm(ks[13], (DEPTH, 2, D, D_FF), D ** -0.5),
        'ffn_w2': nrm(ks[14], (DEPTH, 2, D_FF, D), D_FF ** -0.5),
        'w_in': nrm(ks[15], (DEPTH, D, IN_WIDTH), D ** -0.5),
        'gla_w_up': nrm(ks[16], (DEPTH, 2, GLA_LOW_RANK, GLA_QK), GLA_LOW_RANK ** -0.5),
        'gla_b_up': nrm(ks[17], (DEPTH, 2, GLA_QK), 0.5),
        'gla_norm': 1.0 + nrm(ks[18], (DEPTH, GLA_DV), 0.1),
        'attn_sink': nrm(ks[19], (DEPTH, N_Q_HEADS), 0.5),
        'w_out': nrm(ks[20], (DEPTH, MIX_WIDTH, D), MIX_WIDTH ** -0.5),
    }


def reference(x_prompt, x_sample, cache_k, cache_v, state_gla_fwd, state_gla_bwd, c, c_ctx,
              w_ada, b_ada, norm_pre, norm_post, ffn_w1, ffn_w3, ffn_w2, w_in,
              gla_w_up, gla_b_up, gla_norm, attn_sink, w_out):
    y_prompt = x_prompt
    y_sample = x_sample
    ks_new, vs_new, sf_new, sb_new = [], [], [], []
    for l in range(DEPTH):
        w = {'w_in': w_in[l], 'w_out': w_out[l], 'gla_w_up': gla_w_up[l], 'gla_b_up': gla_b_up[l],
             'gla_norm': gla_norm[l], 'attn_sink': attn_sink[l], 'norm_pre': norm_pre[l],
             'norm_post': norm_post[l], 'ffn_w1': ffn_w1[l], 'ffn_w3': ffn_w3[l], 'ffn_w2': ffn_w2[l]}
        mod_ctx = ada_modulation(c_ctx[None, :], w_ada[l], b_ada[l])
        mod_lat = ada_modulation(c, w_ada[l], b_ada[l])
        y_prompt, (k_l, v_l, sf_l, sb_l) = trunk_layer(
            y_prompt, mod_ctx, w, lambda h: mixer_context(h, w))
        y_sample, _ = trunk_layer(
            y_sample, mod_lat, w,
            lambda h: mixer_latent(h, w, cache_k[:, l], cache_v[:, l], state_gla_fwd[:, l], state_gla_bwd[:, l]))
        ks_new.append(k_l)
        vs_new.append(v_l)
        sf_new.append(sf_l)
        sb_new.append(sb_l)
    new_cache_k = jnp.stack(ks_new, axis=1)
    new_cache_v = jnp.stack(vs_new, axis=1)
    new_state_gla_fwd = jnp.stack(sf_new, axis=1).astype(x_prompt.dtype)
    new_state_gla_bwd = jnp.stack(sb_new, axis=1).astype(x_prompt.dtype)
    return (y_prompt, y_sample, new_cache_k, new_cache_v, new_state_gla_fwd, new_state_gla_bwd)
```

```cpp
#include <hip/hip_runtime.h>
#include <cstdio>
#include <cstdint>

namespace {
constexpr int D = 1024, NCTX = 8192, NLAT = 4096, M = NCTX + NLAT, FF = 2816, INW = 2336, NMOD = 9;
constexpr int CTX_B = 32, CTX_L = 256, LAT_B = 4, LAT_L = 1024;
constexpr float EPS = 1e-6f;

constexpr size_t WS_H = 0;
constexpr size_t WS_O = WS_H + (size_t)M * D * 4;
constexpr size_t WS_U = WS_O + (size_t)M * D * 4;
constexpr size_t WS_G = WS_U + (size_t)M * FF * 4;
constexpr size_t WS_MOD = WS_G + (size_t)2 * M * 256 * 4;
constexpr size_t WS_END = WS_MOD + (size_t)5 * NMOD * D * 4;

__device__ __forceinline__ float siluf(float x) { return x / (1.f + expf(-x)); }
__device__ __forceinline__ int modrow(int m) { return m < NCTX ? 0 : 1 + (m - NCTX) / LAT_L; }

__global__ void k_mod(const float* c, const float* c_ctx, const float* w_ada, const float* b_ada, float* mod) {
    int n = blockIdx.x * 256 + threadIdx.x;
    float acc[5] = {0, 0, 0, 0, 0};
    for (int k = 0; k < D; ++k) {
        float w = w_ada[(size_t)k * (NMOD * D) + n];
        acc[0] += siluf(c_ctx[k]) * w;
        for (int b = 0; b < 4; ++b) acc[1 + b] += siluf(c[b * D + k]) * w;
    }
    for (int r = 0; r < 5; ++r) mod[r * (NMOD * D) + n] = acc[r] + b_ada[n];
}

__device__ __forceinline__ float block_sum_256(float v, float* sh) {
    for (int o = 32; o > 0; o >>= 1) v += __shfl_xor(v, o);
    int w = threadIdx.x >> 6;
    __syncthreads();
    if ((threadIdx.x & 63) == 0) sh[w] = v;
    __syncthreads();
    return sh[0] + sh[1] + sh[2] + sh[3];
}

__global__ void k_prenorm(const float* X, const float* norm_pre, const float* mod, int i, float* H) {
    __shared__ float sh[4];
    int m = blockIdx.x, t = threadIdx.x;
    const float* x = X + (size_t)m * D;
    float v[4], s = 0;
    for (int j = 0; j < 4; ++j) { v[j] = x[t + 256 * j]; s += v[j] * v[j]; }
    s = block_sum_256(s, sh);
    float r = rsqrtf(s / D + EPS);
    const float* md = mod + (size_t)modrow(m) * NMOD * D;
    for (int j = 0; j < 4; ++j) {
        int cidx = t + 256 * j;
        H[(size_t)m * D + cidx] = v[j] * r * norm_pre[i * D + cidx] * (1.f + md[(3 * i + 1) * D + cidx]) + md[(3 * i) * D + cidx];
    }
}

__global__ void k_postres(float* X, const float* O, const float* norm_post, const float* mod, int i, float wgt) {
    __shared__ float sh[4];
    int m = blockIdx.x, t = threadIdx.x;
    const float* o = O + (size_t)m * D;
    float v[4], s = 0;
    for (int j = 0; j < 4; ++j) { v[j] = o[t + 256 * j]; s += v[j] * v[j]; }
    s = block_sum_256(s, sh);
    float r = rsqrtf(s / D + EPS);
    const float* md = mod + (size_t)modrow(m) * NMOD * D;
    for (int j = 0; j < 4; ++j) {
        int cidx = t + 256 * j;
        X[(size_t)m * D + cidx] += wgt * md[(3 * i + 2) * D + cidx] * (v[j] * r * norm_post[i * D + cidx]);
    }
}

template <bool SWIGLU>
__global__ void __launch_bounds__(256) k_gemm(const float* A, const float* B, const float* B2, float* C, int Mm, int N, int K) {
    __shared__ float As[16][64 + 1], Bs[16][64 + 1], Bs2[SWIGLU ? 16 : 1][64 + 1];
    int tx = threadIdx.x & 15, ty = threadIdx.x >> 4;
    int m0 = blockIdx.y * 64, n0 = blockIdx.x * 64;
    float acc[4][4] = {}, acc2[4][4] = {};
    for (int k0 = 0; k0 < K; k0 += 16) {
        for (int e = threadIdx.x; e < 64 * 16; e += 256) {
            int r = e >> 4, kk = e & 15;
            As[kk][r] = A[(size_t)(m0 + r) * K + k0 + kk];
        }
        for (int e = threadIdx.x; e < 64 * 16; e += 256) {
            int kk = e >> 6, cidx = e & 63;
            int n = n0 + cidx;
            Bs[kk][cidx] = n < N ? B[(size_t)(k0 + kk) * N + n] : 0.f;
            if (SWIGLU) Bs2[kk][cidx] = n < N ? B2[(size_t)(k0 + kk) * N + n] : 0.f;
        }
        __syncthreads();
        for (int kk = 0; kk < 16; ++kk) {
            float a[4], b[4], b2[4];
            for (int i = 0; i < 4; ++i) a[i] = As[kk][ty * 4 + i];
            for (int j = 0; j < 4; ++j) { b[j] = Bs[kk][tx * 4 + j]; if (SWIGLU) b2[j] = Bs2[kk][tx * 4 + j]; }
            for (int i = 0; i < 4; ++i) for (int j = 0; j < 4; ++j) { acc[i][j] += a[i] * b[j]; if (SWIGLU) acc2[i][j] += a[i] * b2[j]; }
        }
        __syncthreads();
    }
    for (int i = 0; i < 4; ++i) for (int j = 0; j < 4; ++j) {
        int m = m0 + ty * 4 + i, n = n0 + tx * 4 + j;
        if (n < N) C[(size_t)m * N + n] = SWIGLU ? siluf(acc[i][j]) * acc2[i][j] : acc[i][j];
    }
}

__global__ void k_rope(float* P) {
    int idx = blockIdx.x * 256 + threadIdx.x;
    if (idx >= NLAT * 10 * 32) return;
    int p = idx & 31, hh = (idx >> 5) % 10, r = idx / 320;
    int t = r % LAT_L;
    int i = p & 15; bool second = p >= 16;
    float pos = second ? (float)(t % 64) : (float)(t / 64);
    float inv = powf(10000.f, -(float)(2 * i) / 32.f);
    float ang = pos * inv;
    float cs = cosf(ang), sn = sinf(ang);
    float* base = P + (size_t)(NCTX + r) * INW + hh * 64 + (second ? 32 : 0);
    float x1 = base[i], x2 = base[i + 16];
    base[i] = x1 * cs - x2 * sn;
    base[i + 16] = x1 * sn + x2 * cs;
}

__global__ void k_kvout(const float* P, float* outk, float* outv) {
    int idx = blockIdx.x * 256 + threadIdx.x;
    int m = idx >> 7, cidx = idx & 127;
    outk[idx] = P[(size_t)m * INW + 512 + cidx];
    outv[idx] = P[(size_t)m * INW + 640 + cidx];
}

__global__ void __launch_bounds__(64) k_attn(const float* P, const float* cache_k, const float* cache_v, const float* sink, float* MIX) {
    int idx = blockIdx.x * 64 + threadIdx.x;
    if (idx >= M * 8) return;
    int hq = idx & 7, m = idx >> 3, g = hq >> 2;
    float q[64], o[64];
    for (int d = 0; d < 64; ++d) { q[d] = P[(size_t)m * INW + hq * 64 + d] * 0.125f; o[d] = 0.f; }
    float sk = sink[hq];
    float mx = sk, l = 1.f;
    auto step = [&](const float* kp, const float* vp) {
        float s = 0;
        for (int d = 0; d < 64; ++d) s += q[d] * kp[d];
        if (s > mx) { float f = expf(mx - s); l *= f; for (int d = 0; d < 64; ++d) o[d] *= f; mx = s; }
        float p = expf(s - mx);
        l += p;
        for (int d = 0; d < 64; ++d) o[d] += p * vp[d];
    };
    if (m < NCTX) {
        int b = m / CTX_L;
        for (int j = 0; j < CTX_L; ++j) {
            const float* row = P + (size_t)(b * CTX_L + j) * INW;
            step(row + 512 + g * 64, row + 640 + g * 64);
        }
    } else {
        int r = m - NCTX, b = r / LAT_L, t = r % LAT_L;
        int lo = t - 128 < 0 ? 0 : t - 128, hi = t + 128 > LAT_L - 1 ? LAT_L - 1 : t + 128;
        for (int j = lo; j <= hi; ++j) {
            const float* row = P + (size_t)(NCTX + b * LAT_L + j) * INW;
            step(row + 512 + g * 64, row + 640 + g * 64);
        }
        for (int j = 0; j < 256; ++j) {
            size_t off = ((size_t)(b * 256 + j) * 2 + g) * 64;
            step(cache_k + off, cache_v + off);
        }
    }
    float invl = 1.f / l;
    for (int d = 0; d < 64; ++d) MIX[(size_t)m * D + hq * 64 + d] = o[d] * invl;
}

__global__ void k_gates(const float* P, const float* w_up, const float* b_up, float* G) {
    int idx = blockIdx.x * 256 + threadIdx.x;
    int cidx = idx & 255, m = (idx >> 8) % M, dir = idx / (M * 256);
    const float* lr = P + (size_t)m * INW + 2304 + dir * 16;
    float z = b_up[dir * 256 + cidx];
    for (int j = 0; j < 16; ++j) z += lr[j] * w_up[(dir * 16 + j) * 256 + cidx];
    float ls = fminf(z, 0.f) - log1pf(expf(-fabsf(z)));
    G[idx] = expf(ls * (1.f / 16.f));
}

__global__ void __launch_bounds__(128) k_gla(const float* P, const float* G, const float* s0f, const float* s0b, float* OFB, float* outsf, float* outsb) {
    int u = blockIdx.x;
    int dir = u & 1, h = (u >> 1) & 3, seq = u >> 3;
    int dv = threadIdx.x;
    bool ctx = seq < CTX_B;
    int L = ctx ? CTX_L : LAT_L;
    int row0 = ctx ? seq * CTX_L : NCTX + (seq - CTX_B) * LAT_L;
    float S[64];
    if (ctx) { for (int d = 0; d < 64; ++d) S[d] = 0.f; }
    else {
        const float* s0 = (dir ? s0b : s0f) + ((size_t)((seq - CTX_B) * 4 + h) * 64) * 128;
        for (int d = 0; d < 64; ++d) S[d] = s0[d * 128 + dv];
    }
    for (int i = 0; i < L; ++i) {
        int t = dir ? L - 1 - i : i;
        size_t m = row0 + t;
        const float* prow = P + m * INW;
        const float* g = G + ((size_t)dir * M + m) * 256 + h * 64;
        float v = prow[1280 + h * 128 + dv];
        float o = 0.f;
        for (int d = 0; d < 64; ++d) {
            S[d] = g[d] * S[d] + prow[1024 + h * 64 + d] * v;
            o += prow[768 + h * 64 + d] * 0.125f * S[d];
        }
        OFB[((size_t)dir * M + m) * 512 + h * 128 + dv] = o;
    }
    if (ctx) {
        float* os = (dir ? outsb : outsf) + ((size_t)(seq * 4 + h) * 64) * 128;
        for (int d = 0; d < 64; ++d) os[d * 128 + dv] = S[d];
    }
}

__global__ void __launch_bounds__(128) k_glacomb(const float* P, const float* OFB, const float* gla_norm, float* MIX) {
    __shared__ float sh[2];
    int m = blockIdx.x >> 2, h = blockIdx.x & 3, dv = threadIdx.x;
    float o = OFB[(size_t)m * 512 + h * 128 + dv] + OFB[((size_t)M + m) * 512 + h * 128 + dv];
    float s = o * o;
    for (int k = 32; k > 0; k >>= 1) s += __shfl_xor(s, k);
    if ((dv & 63) == 0) sh[dv >> 6] = s;
    __syncthreads();
    s = sh[0] + sh[1];
    float r = rsqrtf(s / 128.f + EPS);
    float gg = P[(size_t)m * INW + 1792 + h * 128 + dv];
    MIX[(size_t)m * D + 512 + h * 128 + dv] = o * r * gla_norm[dv] * siluf(gg);
}
}

extern "C" void kernel_launch(void* const* d_in, const int* in_sizes, int n_in, void* d_out, int out_size, void* d_ws, size_t ws_size, hipStream_t stream) {
    if (ws_size < WS_END || n_in != 21) { fprintf(stderr, "kernel_launch: bad ws_size %zu (need %zu) or n_in %d\n", ws_size, (size_t)WS_END, n_in); return; }
    const float* x_prompt = (const float*)d_in[0];
    const float* x_sample = (const float*)d_in[1];
    const float* cache_k = (const float*)d_in[2];
    const float* cache_v = (const float*)d_in[3];
    const float* s0f = (const float*)d_in[4];
    const float* s0b = (const float*)d_in[5];
    const float* c = (const float*)d_in[6];
    const float* c_ctx = (const float*)d_in[7];
    const float* w_ada = (const float*)d_in[8];
    const float* b_ada = (const float*)d_in[9];
    const float* norm_pre = (const float*)d_in[10];
    const float* norm_post = (const float*)d_in[11];
    const float* w1 = (const float*)d_in[12];
    const float* w3 = (const float*)d_in[13];
    const float* w2 = (const float*)d_in[14];
    const float* w_in = (const float*)d_in[15];
    const float* w_up = (const float*)d_in[16];
    const float* b_up = (const float*)d_in[17];
    const float* gla_norm = (const float*)d_in[18];
    const float* sink = (const float*)d_in[19];
    const float* w_out = (const float*)d_in[20];
    float* out = (float*)d_out;
    float* X = out;
    float* outk = out + (size_t)M * D;
    float* outv = outk + (size_t)NCTX * 128;
    float* outsf = outv + (size_t)NCTX * 128;
    float* outsb = outsf + (size_t)CTX_B * 4 * 64 * 128;
    char* ws = (char*)d_ws;
    float* H = (float*)(ws + WS_H);
    float* O = (float*)(ws + WS_O);
    float* U = (float*)(ws + WS_U);
    float* P = U;
    float* G = (float*)(ws + WS_G);
    float* mod = (float*)(ws + WS_MOD);
    float* MIX = H;
    float* OFB = O;

    hipMemcpyAsync(X, x_prompt, (size_t)NCTX * D * 4, hipMemcpyDeviceToDevice, stream);
    hipMemcpyAsync(X + (size_t)NCTX * D, x_sample, (size_t)NLAT * D * 4, hipMemcpyDeviceToDevice, stream);
    k_mod<<<NMOD * D / 256, 256, 0, stream>>>(c, c_ctx, w_ada, b_ada, mod);
    k_prenorm<<<M, 256, 0, stream>>>(X, norm_pre, mod, 0, H);
    k_gemm<true><<<dim3(FF / 64, M / 64), 256, 0, stream>>>(H, w1, w3, U, M, FF, D);
    k_gemm<false><<<dim3(D / 64, M / 64), 256, 0, stream>>>(U, w2, nullptr, O, M, D, FF);
    k_postres<<<M, 256, 0, stream>>>(X, O, norm_post, mod, 0, 0.5f);
    k_prenorm<<<M, 256, 0, stream>>>(X, norm_pre, mod, 1, H);
    k_gemm<false><<<dim3((INW + 63) / 64, M / 64), 256, 0, stream>>>(H, w_in, nullptr, P, M, INW, D);
    k_kvout<<<NCTX * 128 / 256, 256, 0, stream>>>(P, outk, outv);
    k_rope<<<(NLAT * 320 + 255) / 256, 256, 0, stream>>>(P);
    k_attn<<<M * 8 / 64, 64, 0, stream>>>(P, cache_k, cache_v, sink, MIX);
    k_gates<<<2 * M * 256 / 256, 256, 0, stream>>>(P, w_up, b_up, G);
    k_gla<<<36 * 4 * 2, 128, 0, stream>>>(P, G, s0f, s0b, OFB, outsf, outsb);
    k_glacomb<<<M * 4, 128, 0, stream>>>(P, OFB, gla_norm, MIX);
    k_gemm<false><<<dim3(D / 64, M / 64), 256, 0, stream>>>(MIX, w_out, nullptr, O, M, D, D);
    k_postres<<<M, 256, 0, stream>>>(X, O, norm_post, mod, 1, 1.0f);
    k_prenorm<<<M, 256, 0, stream>>>(X, norm_pre, mod, 2, H);
    k_gemm<true><<<dim3(FF / 64, M / 64), 256, 0, stream>>>(H, w1 + (size_t)D * FF, w3 + (size_t)D * FF, U, M, FF, D);
    k_gemm<false><<<dim3(D / 64, M / 64), 256, 0, stream>>>(U, w2 + (size_t)FF * D, nullptr, O, M, D, FF);
    k_postres<<<M, 256, 0, stream>>>(X, O, norm_post, mod, 2, 0.5f);
}
```
